# Optimizing an MI355X kernel written in HIP

```python
import math
import jax, jax.numpy as jnp
from jax import lax
import numpy as np

D_MODEL = 1024
BATCH = 4
SEQ = 8192
DEPTH = 1

CTX_LEN = 256
GRID_W = 64
MIX_WIDTH = D_MODEL
LRU_WIDTH = MIX_WIDTH // 2
LRU_BLOCKS = 8
LRU_BLOCK = LRU_WIDTH // LRU_BLOCKS
CONV_W = 4
LRU_C = 8.0
ATT_WIDTH = MIX_WIDTH - LRU_WIDTH
ATT_HEADS = 4
ATT_V_DIM = ATT_WIDTH // ATT_HEADS
ATT_HEAD_DIM = ATT_V_DIM // 2
QK_WIDTH = ATT_HEADS * 2 * ATT_HEAD_DIM
IN_WIDTH = 2 * LRU_WIDTH + 2 * QK_WIDTH + ATT_WIDTH
ROPE_FREQS = ATT_HEAD_DIM // 4
ROPE_BASE = 10000.0
Q_BLOCK = 128
N_GROUPS = 4
EXPERTS_PER_GROUP = 8
N_EXPERTS = N_GROUPS * EXPERTS_PER_GROUP
TOP_K = 2
D_EXPERT = D_MODEL // 2
LN_EPS = 1e-5
DEEPNORM_ALPHA = (2.0 * DEPTH) ** 0.25
DEEPNORM_BETA = (8.0 * DEPTH) ** -0.25

kernel_name = 'hymba_rglru_diffattn_hiermoe_dit_block'


def _ln(x):
    xf = x.astype(jnp.float32)
    mu = jnp.mean(xf, -1, keepdims=True)
    var = jnp.mean(jnp.square(xf - mu), -1, keepdims=True)
    return ((xf - mu) * lax.rsqrt(var + LN_EPS)).astype(x.dtype)


def _post_ln(x, g, b):
    return _ln(x) * g + b


def _modulate(x, shift, scale):
    return _ln(x) * (1 + scale) + shift


def _adaln(cond, w, b):
    m = (jax.nn.silu(cond) @ w + b).reshape(cond.shape[0], 6, 1, D_MODEL)
    return m[:, 0], m[:, 1], m[:, 2], m[:, 3], m[:, 4], m[:, 5]


def _split_in(p):
    return jnp.split(p, [LRU_WIDTH, 2 * LRU_WIDTH, 2 * LRU_WIDTH + QK_WIDTH,
                         2 * LRU_WIDTH + 2 * QK_WIDTH], axis=-1)


def _centred_conv(x, w, b):
    L = x.shape[1]
    left = CONV_W // 2
    xp = jnp.pad(x, ((0, 0), (left, CONV_W - 1 - left), (0, 0)))
    out = b
    for tap in range(CONV_W):
        out = out + w[tap] * xp[:, tap:tap + L]
    return out


def _rglru_coeffs(xc, w_a, b_a, w_i, b_i, lam):
    B, L, W = xc.shape
    xb = xc.reshape(B, L, LRU_BLOCKS, LRU_BLOCK)
    r = jax.nn.sigmoid(jnp.einsum('blnk,nkj->blnj', xb, w_a).reshape(B, L, W) + b_a)
    i = jax.nn.sigmoid(jnp.einsum('blnk,nkj->blnj', xb, w_i).reshape(B, L, W) + b_i)
    log_a = -LRU_C * r.astype(jnp.float32) * jax.nn.softplus(-lam.astype(jnp.float32))
    a = jnp.exp(log_a)
    mult = jnp.sqrt(-jnp.expm1(2.0 * log_a))
    return a, mult * (i * xc).astype(jnp.float32)


def _linear_scan(a, b, h0, reverse):
    if reverse:
        b = b.at[:, -1].add(a[:, -1] * h0)
    else:
        b = b.at[:, 0].add(a[:, 0] * h0)

    def combine(e1, e2):
        a1, b1 = e1
        a2, b2 = e2
        return a1 * a2, a2 * b1 + b2

    _, h = lax.associative_scan(combine, (a, b), axis=1, reverse=reverse)
    return h


def _axial_rope(n_tokens):
    rows = n_tokens // GRID_W
    row = jnp.repeat(jnp.arange(rows, dtype=jnp.float32), GRID_W)
    col = jnp.tile(jnp.arange(GRID_W, dtype=jnp.float32), rows)
    inv = ROPE_BASE ** (-jnp.arange(ROPE_FREQS, dtype=jnp.float32) / ROPE_FREQS)
    ang = jnp.stack([row[:, None] * inv, col[:, None] * inv], axis=1)
    ang = ang[:, None, None]
    return jnp.cos(ang), jnp.sin(ang)


def _rope(t, cos, sin):
    B, L, H, M, d = t.shape
    tr = t.reshape(B, L, H, M, 2, 2, ROPE_FREQS)
    t1, t2 = tr[..., 0, :], tr[..., 1, :]
    out = jnp.stack([t1 * cos - t2 * sin, t2 * cos + t1 * sin], axis=-2)
    return out.reshape(B, L, H, M, d).astype(t.dtype)


def _heads_qk(t):
    return t.reshape(t.shape[0], t.shape[1], ATT_HEADS, 2, ATT_HEAD_DIM)


def _heads_v(t):
    return t.reshape(t.shape[0], t.shape[1], ATT_HEADS, ATT_V_DIM)


def _diff_attend(q, k, v, lam):
    s = jnp.einsum('bqhmd,bkhmd->bhmqk', q, k).astype(jnp.float32) * (ATT_HEAD_DIM ** -0.5)
    p = jax.nn.softmax(s, axis=-1)
    a = p[:, :, 0] - lam * p[:, :, 1]
    return jnp.einsum('bhqk,bkhv->bqhv', a.astype(v.dtype), v)


def _diff_attention_latent(q, k, v, k_c, v_c, lam):
    B, L = q.shape[:2]
    k_all = jnp.concatenate([k, k_c], axis=1)
    v_all = jnp.concatenate([v, v_c], axis=1)
    qb = q.reshape(B, L // Q_BLOCK, Q_BLOCK, ATT_HEADS, 2, ATT_HEAD_DIM).swapaxes(0, 1)
    o = lax.map(lambda blk: _diff_attend(blk, k_all, v_all, lam), qb)
    return o.swapaxes(0, 1).reshape(B, L, ATT_HEADS, ATT_V_DIM)


def _head_rmsnorm(o, g, lam_init):
    of = o.astype(jnp.float32)
    of = of * lax.rsqrt(jnp.mean(jnp.square(of), -1, keepdims=True) + LN_EPS) * (1.0 - lam_init)
    out = of.astype(o.dtype) * g
    return out.reshape(o.shape[0], o.shape[1], ATT_WIDTH)


def _diff_lambda(lp, lam_init):
    lpf = lp.astype(jnp.float32)
    return jnp.exp(jnp.sum(lpf[0] * lpf[1])) - jnp.exp(jnp.sum(lpf[2] * lpf[3])) + lam_init


def _hier_moe(h, wg, bg, we, be, w1, w3, w2):
    gp = jax.nn.softmax((h @ wg + bg).astype(jnp.float32), axis=-1)
    g_sel = jnp.argmax(gp, axis=-1)
    p_g = jnp.max(gp, axis=-1)
    el = jnp.einsum('bld,gde->blge', h, we) + be
    el_sel = jnp.einsum('blge,blg->ble', el.astype(jnp.float32),
                        jax.nn.one_hot(g_sel, N_GROUPS, dtype=jnp.float32))
    ep = jax.nn.softmax(el_sel, axis=-1)
    top_w, top_i = lax.top_k(ep, TOP_K)
    top_w = top_w / jnp.sum(top_w, -1, keepdims=True)
    expert_id = g_sel[..., None] * EXPERTS_PER_GROUP + top_i
    comb = jnp.sum(jax.nn.one_hot(expert_id, N_EXPERTS, dtype=jnp.float32)
                   * (p_g[..., None] * top_w)[..., None], axis=-2).astype(h.dtype)
    y = jnp.zeros_like(h)
    for e in range(N_EXPERTS):
        act = jax.nn.silu(h @ w1[e]) * (h @ w3[e])
        y = y + comb[..., e:e + 1] * (act @ w2[e])
    return y


def setup_inputs(seed: int = 0) -> dict:
    key = jax.random.key(seed)
    ks = jax.random.split(key, 28)
    f32 = jnp.float32
    D = D_MODEL

    def nrm(k, shape, s):
        return s * jax.random.normal(k, shape, f32)

    x = nrm(ks[0], (BATCH, SEQ, D), 1.0)
    c = nrm(ks[1], (BATCH, D), 1.0)
    ctx = nrm(ks[2], (BATCH, CTX_LEN, D), 1.0)
    c_ctx = nrm(ks[3], (D,), 1.0)
    w_mod = nrm(ks[4], (DEPTH, D, 6 * D), 0.1 * D ** -0.5)
    gate_offset = jnp.repeat(jnp.array([0.0, 0.0, 1.0, 0.0, 0.0, 1.0], f32), D)
    b_mod = nrm(ks[5], (DEPTH, 6 * D), 0.05) + gate_offset
    w_in = nrm(ks[6], (DEPTH, D, IN_WIDTH), D ** -0.5)
    w_in = w_in.at[..., IN_WIDTH - ATT_WIDTH:].multiply(DEEPNORM_BETA)
    conv_w = nrm(ks[7], (DEPTH, CONV_W, LRU_WIDTH), CONV_W ** -0.5)
    conv_b = nrm(ks[8], (DEPTH, LRU_WIDTH), 0.02)
    lru_wa = nrm(ks[9], (DEPTH, 2, LRU_BLOCKS, LRU_BLOCK, LRU_BLOCK), LRU_BLOCK ** -0.5)
    lru_ba = nrm(ks[10], (DEPTH, 2, LRU_WIDTH), 0.02)
    lru_wi = nrm(ks[11], (DEPTH, 2, LRU_BLOCKS, LRU_BLOCK, LRU_BLOCK), LRU_BLOCK ** -0.5)
    lru_bi = nrm(ks[12], (DEPTH, 2, LRU_WIDTH), 0.02)
    a0 = jax.random.uniform(ks[13], (DEPTH, 2, LRU_WIDTH), f32, 0.9, 0.999)
    lru_lambda = jnp.log(a0) - jnp.log1p(-a0)
    diff_lambda = nrm(ks[14], (DEPTH, 4, ATT_HEAD_DIM), 0.1)
    attn_norm_g = 1.0 + nrm(ks[15], (DEPTH, ATT_HEADS, ATT_V_DIM), 0.02)
    w_out = nrm(ks[16], (DEPTH, MIX_WIDTH, D), MIX_WIDTH ** -0.5 * DEEPNORM_BETA)
    post_g = 1.0 + nrm(ks[17], (DEPTH, 2, D), 0.02)
    post_b = nrm(ks[18], (DEPTH, 2, D), 0.02)
    router_g_w = nrm(ks[19], (DEPTH, D, N_GROUPS), D ** -0.5)
    router_g_b = nrm(ks[20], (DEPTH, N_GROUPS), 0.01)
    router_e_w = nrm(ks[21], (DEPTH, N_GROUPS, D, EXPERTS_PER_GROUP), D ** -0.5)
    router_e_b = nrm(ks[22], (DEPTH, N_GROUPS, EXPERTS_PER_GROUP), 0.01)
    exp_w1 = nrm(ks[23], (DEPTH, N_EXPERTS, D, D_EXPERT), D ** -0.5 * DEEPNORM_BETA)
    exp_w3 = nrm(ks[24], (DEPTH, N_EXPERTS, D, D_EXPERT), D ** -0.5 * DEEPNORM_BETA)
    exp_w2 = nrm(ks[25], (DEPTH, N_EXPERTS, D_EXPERT, D), D_EXPERT ** -0.5 * DEEPNORM_BETA)
    return {'x': x, 'c': c, 'ctx': ctx, 'c_ctx': c_ctx, 'w_mod': w_mod, 'b_mod': b_mod,
            'w_in': w_in, 'conv_w': conv_w, 'conv_b': conv_b, 'lru_wa': lru_wa, 'lru_ba': lru_ba,
            'lru_wi': lru_wi, 'lru_bi': lru_bi, 'lru_lambda': lru_lambda, 'diff_lambda': diff_lambda,
            'attn_norm_g': attn_norm_g, 'w_out': w_out, 'post_g': post_g, 'post_b': post_b,
            'router_g_w': router_g_w, 'router_g_b': router_g_b, 'router_e_w': router_e_w,
            'router_e_b': router_e_b, 'exp_w1': exp_w1, 'exp_w3': exp_w3, 'exp_w2': exp_w2}


def reference(x, c, ctx, c_ctx, w_mod, b_mod, w_in, conv_w, conv_b, lru_wa, lru_ba, lru_wi, lru_bi,
              lru_lambda, diff_lambda, attn_norm_g, w_out, post_g, post_b, router_g_w, router_g_b,
              router_e_w, router_e_b, exp_w1, exp_w3, exp_w2):
    cos, sin = _axial_rope(x.shape[1])
    for l in range(DEPTH):
        lam_init = 0.8 - 0.6 * math.exp(-0.3 * l)
        sh1, sc1, g1, sh2, sc2, g2 = _adaln(c, w_mod[l], b_mod[l])
        sh1c, sc1c, g1c, sh2c, sc2c, g2c = _adaln(c_ctx[None], w_mod[l], b_mod[l])

        u, gt, q, k, v = _split_in(_modulate(x, sh1, sc1) @ w_in[l])
        u_c, gt_c, q_c, k_c, v_c = _split_in(_modulate(ctx, sh1c, sc1c) @ w_in[l])

        xc = _centred_conv(u, conv_w[l], conv_b[l])
        xc_c = _centred_conv(u_c, conv_w[l], conv_b[l])
        rec = jnp.zeros(xc.shape, jnp.float32)
        ctx_states = []
        for d in range(2):
            rev = d == 1
            a_c, b_c = _rglru_coeffs(xc_c, lru_wa[l, d], lru_ba[l, d], lru_wi[l, d], lru_bi[l, d], lru_lambda[l, d])
            h_c = _linear_scan(a_c, b_c, jnp.zeros_like(b_c[:, 0]), rev)
            ctx_states.append(h_c)
            h0 = h_c[:, 0] if rev else h_c[:, -1]
            a_x, b_x = _rglru_coeffs(xc, lru_wa[l, d], lru_ba[l, d], lru_wi[l, d], lru_bi[l, d], lru_lambda[l, d])
            rec = rec + _linear_scan(a_x, b_x, h0, rev)
        y_lru = jax.nn.gelu(gt) * rec.astype(x.dtype)

        lam = _diff_lambda(diff_lambda[l], lam_init)
        q_h = _rope(_heads_qk(q), cos, sin)
        k_h = _rope(_heads_qk(k), cos, sin)
        k_ch = _heads_qk(k_c)
        v_ch = _heads_v(v_c)
        o = _diff_attention_latent(q_h, k_h, _heads_v(v), k_ch, v_ch, lam)
        y_att = _head_rmsnorm(o, attn_norm_g[l], lam_init)

        mix = jnp.concatenate([y_lru, y_att], axis=-1) @ w_out[l]
        x_mid = _post_ln(DEEPNORM_ALPHA * x + g1 * mix, post_g[l, 0], post_b[l, 0])
        y_ffn = _hier_moe(_modulate(x_mid, sh2, sc2), router_g_w[l], router_g_b[l], router_e_w[l],
                          router_e_b[l], exp_w1[l], exp_w3[l], exp_w2[l])
        x_new = _post_ln(DEEPNORM_ALPHA * x_mid + g2 * y_ffn, post_g[l, 1], post_b[l, 1])

        if l + 1 < DEPTH:
            y_lru_c = jax.nn.gelu(gt_c) * (ctx_states[0] + ctx_states[1]).astype(ctx.dtype)
            o_c = _diff_attend(_heads_qk(q_c), k_ch, v_ch, lam)
            y_att_c = _head_rmsnorm(o_c, attn_norm_g[l], lam_init)
            mix_c = jnp.concatenate([y_lru_c, y_att_c], axis=-1) @ w_out[l]
            ctx_mid = _post_ln(DEEPNORM_ALPHA * ctx + g1c * mix_c, post_g[l, 0], post_b[l, 0])
            y_ffn_c = _hier_moe(_modulate(ctx_mid, sh2c, sc2c), router_g_w[l], router_g_b[l], router_e_w[l],
                                router_e_b[l], exp_w1[l], exp_w3[l], exp_w2[l])
            ctx = _post_ln(DEEPNORM_ALPHA * ctx_mid + g2c * y_ffn_c, post_g[l, 1], post_b[l, 1])
        x = x_new
    return x
```

```cpp
#include <hip/hip_runtime.h>
#include <cstdio>
#include <cstdint>

#ifndef MK_N_LAUNCHES
#define MK_N_LAUNCHES 10
#endif

#define GAS __attribute__((address_space(1)))
#define LAS __attribute__((address_space(3)))
typedef unsigned short bf16_t;
typedef short bf16x8 __attribute__((ext_vector_type(8)));
typedef short s16x4 __attribute__((ext_vector_type(4)));
typedef float f32x2 __attribute__((ext_vector_type(2)));
typedef float f32x4 __attribute__((ext_vector_type(4)));
typedef float f32x16 __attribute__((ext_vector_type(16)));
typedef unsigned u32x2 __attribute__((ext_vector_type(2)));
typedef unsigned u32x4 __attribute__((ext_vector_type(4)));
typedef GAS unsigned gu32;

constexpr int D = 1024, NB = 4, SEQ = 8192, NTOK = NB * SEQ, CTXL = 256, NCTX = NB * CTXL, MROWS = NTOK + NCTX;
constexpr int INW = 2560, LRUW = 512, NHEAD = 4, KVLEN = SEQ + CTXL, NKT = KVLEN / 64;
constexpr int NEXP = 32, DEXP = 512, ECAP = NTOK;
constexpr float LN_EPS = 1e-5f, LOG2E = 1.4426950408889634f;
constexpr float ALPHA = 1.189207115002721f;
constexpr float LAM_INIT = 0.2f;
constexpr float QSCALE = 0.125f * LOG2E;
constexpr int NCHUNK = SEQ / 128, NSUMC = NCHUNK + 2;

constexpr size_t MiB = 1u << 20;
constexpr size_t WS_CTL = 0, CTL_ZERO_BYTES = 1 * MiB;
constexpr size_t WS_MODS = 1 * MiB;
constexpr size_t WS_ROPE = 1 * MiB + 128 * 1024;
constexpr size_t WS_LRUW = 1 * MiB + 256 * 1024;
constexpr size_t WS_SUM = 2 * MiB;
constexpr size_t WS_LENT = 5 * MiB, WS_LWGT = 9 * MiB;
constexpr size_t WS_WIN = 16 * MiB, WS_WOUT = 21 * MiB, WS_BT1 = 24 * MiB, WS_BT2 = 88 * MiB;
constexpr size_t WS_A = 120 * MiB;
constexpr size_t WS_Q = 186 * MiB, WS_K = 218 * MiB, WS_V = 251 * MiB;
constexpr size_t WS_ACT = 186 * MiB;
constexpr size_t WS_U = 284 * MiB, WS_G = 317 * MiB;
constexpr size_t WS_HS = 349 * MiB, WS_PF = 381 * MiB, WS_PB = 413 * MiB;
constexpr size_t WS_YS = 284 * MiB;
constexpr size_t WS_END = 445 * MiB;
constexpr int CW_BAR = 4096, CW_CNT = 16384;

constexpr int LDS_BYTES = 163840, MISC_OFF = 159744;
constexpr int NWAVES = 8, NTHR = 512;

#define RLX_AGENT __ATOMIC_RELAXED, __HIP_MEMORY_SCOPE_AGENT
#define LDS_WAIT() asm volatile("s_waitcnt lgkmcnt(0)" ::: "memory")
#define VM_WAIT() asm volatile("s_waitcnt vmcnt(0)" ::: "memory")

__device__ __forceinline__ unsigned cvt_pk_bf16(float lo, float hi) { unsigned r; asm volatile("v_cvt_pk_bf16_f32 %0, %1, %2" : "=v"(r) : "v"(lo), "v"(hi)); return r; }
__device__ __forceinline__ float bf2f(unsigned short b) { return __builtin_bit_cast(float, (unsigned)b << 16); }
__device__ __forceinline__ float bflo(unsigned w) { return __builtin_bit_cast(float, w << 16); }
__device__ __forceinline__ float bfhi(unsigned w) { return __builtin_bit_cast(float, w & 0xffff0000u); }
__device__ __forceinline__ float fexp2(float x) { return __builtin_amdgcn_exp2f(x); }
__device__ __forceinline__ float frcp(float x) { return __builtin_amdgcn_rcpf(x); }
__device__ __forceinline__ float sigmoidf_(float x) { return frcp(1.f + fexp2(-x * LOG2E)); }
__device__ __forceinline__ float wave_sum(float v) {
#pragma unroll
    for (int o = 1; o < 64; o <<= 1) v += __shfl_xor(v, o);
    return v;
}
__device__ __forceinline__ int crow(int r, int hi) { return (r & 3) + 8 * (r >> 2) + 4 * hi; }

#define XB_TMO      128
#define XB_XCNT(j)  (256  + 64 * (j))
#define XB_XSUB(j)  (1280 + 64 * (j))
#define XB_XGEN(j)  (2304 + 64 * (j))
#define XB_TOP      3328
#define XB_TOPGEN   3392
#define XCD_BAR_WORDS 3456
#define XB_SPIN_CAP (1u << 18)
__device__ __forceinline__ unsigned xb_ld(unsigned* p)              { return __hip_atomic_load(p, __ATOMIC_RELAXED, __HIP_MEMORY_SCOPE_AGENT); }
__device__ __forceinline__ unsigned xb_add(unsigned* p, unsigned v) { return __hip_atomic_fetch_add(p, v, __ATOMIC_RELAXED, __HIP_MEMORY_SCOPE_AGENT); }
__device__ __forceinline__ unsigned xb_xcc_id() { return (unsigned)__builtin_amdgcn_s_getreg((3 << 11) | 20) & 0xFu; }
#define XB_SPIN(cond, bar) do { unsigned _sp = 0; while (cond) { __builtin_amdgcn_s_sleep(1); \
    if ((++_sp & 255u) == 0u) { if (xb_ld(&(bar)[XB_TMO])) break; if (_sp > XB_SPIN_CAP) { atomicAdd(&(bar)[XB_TMO], 1u); break; } } } } while (0)
struct XcdBarrier { unsigned* bar; unsigned x; volatile LAS unsigned* st; };
__device__ __forceinline__ XcdBarrier xcd_barrier_post(unsigned* bar, volatile LAS unsigned* st) {
    XcdBarrier b; b.bar = bar; b.x = xb_xcc_id(); b.st = st;
    if (threadIdx.x == 0) (void)xb_add(&bar[XB_XCNT(b.x)], 1u);
    return b;
}
__device__ __forceinline__ void xcd_barrier_complete(unsigned* bar, unsigned x, unsigned& nloc, unsigned& nx) {
    const unsigned G = gridDim.x * gridDim.y * gridDim.z;
    unsigned sum, cnt, mine, sp = 0u;
    for (;;) {
        sum = 0u; cnt = 0u; mine = 0u;
#pragma unroll
        for (unsigned j = 0; j < 16; ++j) { const unsigned c = xb_ld(&bar[XB_XCNT(j)]); sum += c; cnt += (c > 0u) ? 1u : 0u; mine = (j == x) ? c : mine; }
        if (sum == G) break;
        __builtin_amdgcn_s_sleep(1);
        if ((++sp & 255u) == 0u) { if (xb_ld(&bar[XB_TMO])) break; if (sp > XB_SPIN_CAP) { atomicAdd(&bar[XB_TMO], 1u); break; } }
    }
    nloc = mine > 0u ? mine : 1u; nx = cnt > 0u ? cnt : 1u;
}
__device__ __forceinline__ void xcd_barrier(const XcdBarrier& b) {
    asm volatile("s_waitcnt vmcnt(0)" ::: "memory");
    __syncthreads();
    if (threadIdx.x == 0) {
        unsigned* bar = b.bar;
        __builtin_amdgcn_s_waitcnt(0);
        unsigned nloc = b.st[0], nx = b.st[1];
        if (nloc == 0u) { xcd_barrier_complete(bar, b.x, nloc, nx); b.st[0] = nloc; b.st[1] = nx; }
        const unsigned old = xb_add(&bar[XB_XSUB(b.x)], 1u);
        const unsigned gen = old / nloc;
        if (old + 1u == (gen + 1u) * nloc) {
            __builtin_amdgcn_fence(__ATOMIC_RELEASE, "agent");
            asm volatile("s_waitcnt vmcnt(0)" ::: "memory");
            const unsigned og = xb_add(&bar[XB_TOP], 1u);
            const unsigned tg = og / nx;
            if (og + 1u == (tg + 1u) * nx) xb_add(&bar[XB_TOPGEN], 1u);
            else XB_SPIN(xb_ld(&bar[XB_TOPGEN]) == tg, bar);
            __builtin_amdgcn_fence(__ATOMIC_ACQUIRE, "agent");
            xb_add(&bar[XB_XGEN(b.x)], 1u);
            asm volatile("s_waitcnt vmcnt(0)" ::: "memory");
        } else {
            XB_SPIN(xb_ld(&bar[XB_XGEN(b.x)]) == gen, bar);
            __builtin_amdgcn_fence(__ATOMIC_ACQUIRE, "agent");
            asm volatile("s_waitcnt vmcnt(0)" ::: "memory");
        }
    }
    __syncthreads();
}

struct Frame {
    LAS unsigned char* lds;
    volatile LAS unsigned* MISC;
    unsigned char* ws;
    const float* const* in;
    float* out;
    int tid, lane, wave, vcu, G;
};
#define IN_X 0
#define IN_C 1
#define IN_CTX 2
#define IN_CCTX 3
#define IN_WMOD 4
#define IN_BMOD 5
#define IN_WIN 6
#define IN_CONVW 7
#define IN_CONVB 8
#define IN_LRUWA 9
#define IN_LRUBA 10
#define IN_LRUWI 11
#define IN_LRUBI 12
#define IN_LRULAM 13
#define IN_DLAM 14
#define IN_ANG 15
#define IN_WOUT 16
#define IN_POSTG 17
#define IN_POSTB 18
#define IN_RGW 19
#define IN_RGB 20
#define IN_REW 21
#define IN_REB 22
#define IN_W1 23
#define IN_W3 24
#define IN_W2 25

namespace pg8 {
constexpr int BM = 256, BK = 64, HALF = 128, HTB = HALF * BK * 2, STAGE_BYTES = 8 * HTB, NXCD = 8, WGM = 8;
__host__ __device__ __forceinline__ int lds_byte(int r, int c) { const int st = (r >> 4) * 2 + (c >> 5), rr = r & 15, cc = c & 31, ob = rr * 64 + cc * 2; return st * 1024 + (ob ^ (((ob >> 9) & 1) << 5)); }
__host__ __device__ __forceinline__ void stage_rc(int b, int& R, int& C) { const int st = b / 1024, sb = b % 1024, swz = sb ^ (((sb >> 9) & 1) << 5); R = (st >> 1) * 16 + swz / 64; C = (st & 1) * 32 + (swz % 64) / 2; }
__host__ __device__ __forceinline__ int perm32(int rho) { const int n = rho >> 4, i = rho & 15; return 8 * (i >> 2) + 4 * n + (i & 3); }

struct Unit { int pm, pn, e, cnt, tile; };

__device__ __forceinline__ void tile_of(int wgid, int nM, int nN, int& pm, int& pn) {
    const int nwg = nM * nN;
    { const int q = nwg / NXCD, r = nwg % NXCD, xcd = wgid % NXCD, off = wgid / NXCD; wgid = (xcd < r ? xcd * (q + 1) : r * (q + 1) + (xcd - r) * q) + off; }
    const int nig = WGM * nN, gid = wgid / nig, fm = gid * WGM, gsz = (nM - fm) < WGM ? (nM - fm) : WGM;
    pm = fm + ((wgid % nig) % gsz); pn = (wgid % nig) / gsz;
}

template <class Epi, class Sched, bool ALIGN_EPI, bool GATHER>
__device__ __forceinline__ void gemm_phase(LAS unsigned char* lds, const int K, const Sched& S, const Epi& E) {
    const int tid = threadIdx.x, wid = __builtin_amdgcn_readfirstlane(tid >> 6), lane = tid & 63, wr = wid >> 2, wc = wid & 3, fr = lane & 15, fq = lane >> 4;
    const int nt = K / BK;
    int R[2], C[2];
    unsigned vc[2][2], vn[2][2], voffB[2];
#pragma unroll
    for (int i = 0; i < 2; ++i) { stage_rc(tid * 16 + i * 8192, R[i], C[i]); const int Rb = (R[i] & ~31) + perm32(R[i] & 31);
        voffB[i] = (unsigned)(Rb * K + C[i]) * 2u;
        vc[0][i] = (unsigned)(R[i] * K + C[i]) * 2u; vc[1][i] = (unsigned)((R[i] + HALF) * K + C[i]) * 2u; vn[0][i] = vc[0][i]; vn[1][i] = vc[1][i]; }
    const size_t kstep = (size_t)(BK * 2);
    const size_t hstep = (size_t)HALF * K * 2;
    const unsigned ldsw = (unsigned)wid * 1024u;
    const int aoff = lds_byte(wr * 64 + fr, fq * 8), boff = lds_byte(wc * 32 + fr, fq * 8);
#define PG8_SA(b, h) (((b) * 2 + (h)) * HTB)
#define PG8_SB(b, h) ((4 + (b) * 2 + (h)) * HTB)
#define PG8_STAGE(bufoff, gbase, voff) do { _Pragma("unroll") for (int _i = 0; _i < 2; ++_i) \
        __builtin_amdgcn_global_load_lds((const unsigned*)((const char*)(gbase) + (voff)[_i]), (LAS unsigned*)(lds + (bufoff) + ldsw + _i * 8192), 16, 0, 0); } while (0)
#define PG8_LDA(dst, b, h) do { _Pragma("unroll") for (int m = 0; m < 4; ++m) _Pragma("unroll") for (int k = 0; k < 2; ++k) dst[m][k] = *(const LAS bf16x8*)(lds + PG8_SA(b, h) + aoff + m * 2048 + k * 1024); } while (0)
#define PG8_LDB(dst, b, h) do { _Pragma("unroll") for (int n = 0; n < 2; ++n) _Pragma("unroll") for (int k = 0; k < 2; ++k) dst[n][k] = *(const LAS bf16x8*)(lds + PG8_SB(b, h) + boff + n * 2048 + k * 1024); } while (0)
#define PG8_MMA(ai, bj, At, Bt) do { __builtin_amdgcn_s_setprio(1); _Pragma("unroll") for (int m = 0; m < 4; ++m) _Pragma("unroll") for (int n = 0; n < 2; ++n) _Pragma("unroll") for (int k = 0; k < 2; ++k) \
        acc[ai][bj][m][n] = __builtin_amdgcn_mfma_f32_16x16x32_bf16(Bt[n][k], At[m][k], acc[ai][bj][m][n], 0, 0, 0); __builtin_amdgcn_s_setprio(0); } while (0)
#define PG8_WAIT_V(n) asm volatile("s_waitcnt vmcnt(" #n ")" ::: "memory")
#define PG8_WAIT_L(n) asm volatile("s_waitcnt lgkmcnt(" #n ")" ::: "memory")
#define PG8_BAR __builtin_amdgcn_s_barrier()
#define PG8_SCHED __builtin_amdgcn_sched_barrier(0)
    Unit cur, nxt; int ui = 0;
    if (!S.next(0, cur)) return;
    if constexpr (GATHER) S.a_offs(cur, R, C, vc);
    f32x4 acc[2][2][4][2];
#pragma unroll
    for (int a = 0; a < 2; ++a)
#pragma unroll
        for (int b = 0; b < 2; ++b)
#pragma unroll
            for (int m = 0; m < 4; ++m)
#pragma unroll
                for (int n = 0; n < 2; ++n) acc[a][b][m][n] = (f32x4){0.f, 0.f, 0.f, 0.f};
    bf16x8 At[4][2], B0[2][2], B1[2][2];
    const char* cA = S.a_base(cur); const char* cB = S.b_base(cur);
    PG8_STAGE(PG8_SB(0, 0), cB, voffB); PG8_STAGE(PG8_SB(0, 1), cB + hstep, voffB); PG8_STAGE(PG8_SA(0, 0), cA, vc[0]); PG8_STAGE(PG8_SA(0, 1), cA, vc[1]);
    if (wr == 1) PG8_BAR;
    PG8_WAIT_V(2); PG8_BAR;
    PG8_STAGE(PG8_SB(1, 0), cB + kstep, voffB); PG8_STAGE(PG8_SA(1, 0), cA + kstep, vc[0]); PG8_STAGE(PG8_SB(1, 1), cB + hstep + kstep, voffB);
    PG8_WAIT_V(6); PG8_BAR;
    for (;;) {
        const bool has_next = S.next(ui + 1, nxt);
        if constexpr (GATHER) { if (has_next) S.a_offs(nxt, R, C, vn); }
        const char* nA = has_next ? S.a_base(nxt) : cA; const char* nB = has_next ? S.b_base(nxt) : cB;
        for (int t = 0; t < nt; t += 2) {
            const bool last = (t == nt - 2);
            const char* a1 = cA + (size_t)(t + 1) * kstep;
            const char* a2 = last ? nA : cA + (size_t)(t + 2) * kstep; const char* b2 = last ? nB : cB + (size_t)(t + 2) * kstep;
            const char* a3 = a2 + kstep; const char* b3 = b2 + kstep;
            unsigned va[2][2];
#pragma unroll
            for (int h = 0; h < 2; ++h)
#pragma unroll
                for (int i = 0; i < 2; ++i) va[h][i] = (GATHER && last && has_next) ? vn[h][i] : vc[h][i];
            PG8_LDB(B0, 0, 0); PG8_LDB(B1, 0, 1); PG8_SCHED; PG8_LDA(At, 0, 0); PG8_STAGE(PG8_SA(1, 1), a1, vc[1]);
            PG8_WAIT_V(8); PG8_WAIT_L(0); PG8_BAR; PG8_MMA(0, 0, At, B0); PG8_MMA(0, 1, At, B1); PG8_BAR; PG8_SCHED;
            PG8_LDA(At, 0, 1); PG8_STAGE(PG8_SB(0, 0), b2, voffB); PG8_STAGE(PG8_SB(0, 1), b2 + hstep, voffB); PG8_STAGE(PG8_SA(0, 0), a2, va[0]);
            PG8_WAIT_V(8); PG8_WAIT_L(0); PG8_BAR; PG8_MMA(1, 0, At, B0); PG8_MMA(1, 1, At, B1); PG8_BAR; PG8_SCHED;
            PG8_LDB(B0, 1, 0); PG8_LDB(B1, 1, 1); PG8_SCHED; PG8_LDA(At, 1, 0); PG8_STAGE(PG8_SA(0, 1), a2, va[1]);
            PG8_WAIT_V(8); PG8_WAIT_L(0); PG8_BAR; PG8_MMA(0, 0, At, B0); PG8_MMA(0, 1, At, B1); PG8_BAR; PG8_SCHED;
            PG8_LDA(At, 1, 1); PG8_STAGE(PG8_SB(1, 0), b3, voffB); PG8_STAGE(PG8_SB(1, 1), b3 + hstep, voffB); PG8_STAGE(PG8_SA(1, 0), a3, va[0]);
            PG8_WAIT_V(8); PG8_WAIT_L(0); PG8_BAR; PG8_MMA(1, 0, At, B0); PG8_MMA(1, 1, At, B1); PG8_BAR; PG8_SCHED;
        }
        if constexpr (ALIGN_EPI) { if (wr == 0) PG8_BAR; }
        E(acc, cur, wr, wc, fr, fq);
        if (!has_next) break;
#pragma unroll
        for (int a = 0; a < 2; ++a)
#pragma unroll
            for (int b = 0; b < 2; ++b)
#pragma unroll
                for (int m = 0; m < 4; ++m)
#pragma unroll
                    for (int n = 0; n < 2; ++n) acc[a][b][m][n] = (f32x4){0.f, 0.f, 0.f, 0.f};
        cur = nxt; cA = nA; cB = nB; ++ui;
#pragma unroll
        for (int h = 0; h < 2; ++h)
#pragma unroll
            for (int i = 0; i < 2; ++i) vc[h][i] = vn[h][i];
        if constexpr (ALIGN_EPI) { if (wr == 1) PG8_BAR; }
    }
    PG8_WAIT_V(0);
    if constexpr (!ALIGN_EPI) { if (wr == 0) PG8_BAR; }
    PG8_BAR;
#undef PG8_SA
#undef PG8_SB
#undef PG8_STAGE
#undef PG8_LDA
#undef PG8_LDB
#undef PG8_MMA
#undef PG8_WAIT_V
#undef PG8_WAIT_L
#undef PG8_BAR
#undef PG8_SCHED
}
}

__device__ __forceinline__ void transpose_item(const float* W, int srcN, bf16_t* WT, int dstK, int k0, int n0, int drow0, bool qkperm, LAS float* scr, int lane) {
#pragma unroll 8
    for (int i = 0; i < 32; ++i) { const int kk = 2 * i + (lane >> 5); scr[kk * 33 + (lane & 31)] = W[(size_t)(k0 + kk) * srcN + n0 + (lane & 31)]; }
    LDS_WAIT(); asm volatile("" ::: "memory");
    const int c = lane & 7;
#pragma unroll
    for (int j = 0; j < 4; ++j) { const int n = (lane >> 3) + 8 * j; const int ns = qkperm ? (((n & 1) << 4) | (n >> 1)) : n; const LAS float* s = scr + (8 * c) * 33 + ns;
        u32x4 o; o.x = cvt_pk_bf16(s[0 * 33], s[1 * 33]); o.y = cvt_pk_bf16(s[2 * 33], s[3 * 33]); o.z = cvt_pk_bf16(s[4 * 33], s[5 * 33]); o.w = cvt_pk_bf16(s[6 * 33], s[7 * 33]);
        *(GAS u32x4*)(WT + (size_t)(drow0 + n) * dstK + k0 + 8 * c) = o; }
    LDS_WAIT(); asm volatile("" ::: "memory");
}
__device__ __forceinline__ void sincos_d(double a, float& c, float& s) {
    const double TWO_PI = 6.283185307179586476925286766559, INV_2PI = 0.15915494309189533576888376337251;
    const double n = __builtin_rint(a * INV_2PI); const double r = a - n * TWO_PI, r2 = r * r;
    double sv = 1.0, cv = 1.0;
#pragma unroll
    for (int k = 14; k >= 1; --k) { sv = 1.0 - sv * r2 / (double)((2 * k) * (2 * k + 1)); cv = 1.0 - cv * r2 / (double)((2 * k - 1) * (2 * k)); }
    s = (float)(sv * r); c = (float)cv;
}
__device__ __forceinline__ void p0_prologue(Frame& F) {
    {
        LAS float* sc = (LAS float*)F.lds;
        LAS float* red = sc + 5 * 1024;
        for (int i = F.tid; i < 5 * 1024; i += NTHR) { const int n = i >> 10, k = i & 1023; const float v = (n < 4) ? F.in[IN_C][n * 1024 + k] : F.in[IN_CCTX][k]; sc[i] = v * sigmoidf_(v); }
        __syncthreads();
        const float* W = F.in[IN_WMOD]; const float* bm = F.in[IN_BMOD]; float* mods = (float*)(F.ws + WS_MODS);
        for (int cg = blockIdx.x; cg < 256; cg += F.G) {
            const int kg = F.tid >> 5, jj = F.tid & 31, col = cg * 24 + jj;
            float a[5] = {0.f, 0.f, 0.f, 0.f, 0.f};
            if (jj < 24) {
#pragma unroll 8
                for (int k = kg * 64; k < kg * 64 + 64; ++k) { const float w = W[(size_t)k * 6144 + col];
#pragma unroll
                    for (int n = 0; n < 5; ++n) a[n] += sc[n * 1024 + k] * w; }
            }
#pragma unroll
            for (int n = 0; n < 5; ++n) red[(kg * 5 + n) * 32 + jj] = a[n];
            __syncthreads();
            if (F.tid < 160) { const int n = F.tid >> 5, j2 = F.tid & 31; if (j2 < 24) { float s = 0.f;
#pragma unroll
                for (int g = 0; g < 16; ++g) s += red[(g * 5 + n) * 32 + j2];
                mods[n * 6144 + cg * 24 + j2] = s + bm[cg * 24 + j2]; } }
            __syncthreads();
        }
    }
    const int gt = blockIdx.x * NTHR + F.tid, NGT = F.G * NTHR;
    for (int i = gt; i < 128 * 16; i += NGT) {
        const int pos = i >> 4, f = i & 15;
        const double inv4[4] = {1.0, 0.56234132519034908, 0.31622776601683794, 0.17782794100389228};
        double inv = inv4[f & 3]; const int dec = f >> 2; inv = (dec == 1) ? inv * 0.1 : (dec == 2) ? inv * 0.01 : (dec == 3) ? inv * 0.001 : inv;
        float c, s; sincos_d((double)pos * (double)(float)inv, c, s);
        float* rt = (float*)(F.ws + WS_ROPE); rt[2 * i] = c; rt[2 * i + 1] = s;
    }
    for (int i = gt; i < 2 * 2 * 8 * 64 * 64; i += NGT) {
        const int k = i & 63, j = (i >> 6) & 63, n = (i >> 12) & 7, type = (i >> 15) & 1, dir = i >> 16;
        const float* src = type ? F.in[IN_LRUWI] : F.in[IN_LRUWA];
        const float v = src[((dir * 8 + n) * 64 + k) * 64 + j];
        ((bf16_t*)(F.ws + WS_LRUW))[i] = (bf16_t)(cvt_pk_bf16(v, 0.f) & 0xffffu);
    }
    LAS float* scr = (LAS float*)(F.lds + 32768 + F.wave * 8448);
    const int gw = F.vcu * NWAVES + F.wave, NGW = F.G * NWAVES;
    constexpr int I_IN = 16 * 80, I_OUT = 16 * 32, I_E13 = 16 * 16, I_E2 = 8 * 32;
    constexpr int NITEMS = I_IN + I_OUT + NEXP * (2 * I_E13 + I_E2);
    for (int it = gw; it < NITEMS; it += NGW) {
        int r = it;
        if (r < I_IN) { const int kb = r / 80, nb = r % 80, n0 = nb * 32; transpose_item(F.in[IN_WIN], INW, (bf16_t*)(F.ws + WS_WIN), D, kb * 64, n0, n0, (n0 >= 1024 && n0 < 2048), scr, F.lane); continue; } r -= I_IN;
        if (r < I_OUT) { const int kb = r / 32, nb = r % 32; transpose_item(F.in[IN_WOUT], D, (bf16_t*)(F.ws + WS_WOUT), D, kb * 64, nb * 32, nb * 32, false, scr, F.lane); continue; } r -= I_OUT;
        const int e = r / (2 * I_E13 + I_E2); r -= e * (2 * I_E13 + I_E2);
        if (r < 2 * I_E13) { const int which = r / I_E13; r -= which * I_E13; const int kb = r / 16, nb = r % 16, n0 = nb * 32;
            const float* src = (which ? F.in[IN_W3] : F.in[IN_W1]) + (size_t)e * D * DEXP;
            transpose_item(src, DEXP, (bf16_t*)(F.ws + WS_BT1) + (size_t)e * 1024 * 1024, D, kb * 64, n0, 256 * (n0 >> 7) + 128 * which + (n0 & 127), false, scr, F.lane); continue; }
        r -= 2 * I_E13;
        { const int kb = r / 32, nb = r % 32; transpose_item(F.in[IN_W2] + (size_t)e * DEXP * D, D, (bf16_t*)(F.ws + WS_BT2) + (size_t)e * 1024 * 512, DEXP, kb * 64, nb * 32, nb * 32, false, scr, F.lane); }
    }
}

__device__ __forceinline__ void p1_ln1(Frame& F) {
    const int gw = F.vcu * NWAVES + F.wave, NGW = F.G * NWAVES;
    const float* mods = (const float*)(F.ws + WS_MODS);
    for (int r = gw; r < MROWS; r += NGW) {
        const float* xrow = (r < NTOK) ? F.in[IN_X] + (size_t)r * D : F.in[IN_CTX] + (size_t)(r - NTOK) * D;
        const int n = (r < NTOK) ? (r >> 13) : 4;
        const GAS f32x4* xr = (const GAS f32x4*)xrow + F.lane;
        const GAS f32x4* sh = (const GAS f32x4*)(mods + n * 6144) + F.lane; const GAS f32x4* scp = (const GAS f32x4*)(mods + n * 6144 + 1024) + F.lane;
        f32x4 v[4]; float s = 0.f;
#pragma unroll
        for (int j = 0; j < 4; ++j) { v[j] = xr[64 * j]; s += (v[j].x + v[j].y) + (v[j].z + v[j].w); }
        const float mean = wave_sum(s) * (1.f / D); float s2 = 0.f;
#pragma unroll
        for (int j = 0; j < 4; ++j) { v[j] = v[j] - mean; s2 += (v[j].x * v[j].x + v[j].y * v[j].y) + (v[j].z * v[j].z + v[j].w * v[j].w); }
        const float rstd = 1.f / sqrtf(wave_sum(s2) * (1.f / D) + LN_EPS);
        GAS u32x2* o8 = (GAS u32x2*)((bf16_t*)(F.ws + WS_A) + (size_t)r * D) + F.lane;
#pragma unroll
        for (int j = 0; j < 4; ++j) { const f32x4 a = sh[64 * j], b = scp[64 * j]; const f32x4 h = v[j] * rstd * (b + 1.f) + a;
            u32x2 w; w.x = cvt_pk_bf16(h.x, h.y); w.y = cvt_pk_bf16(h.z, h.w); o8[64 * j] = w; }
    }
}

struct SchedInProj {
    int G, c;
    __device__ __forceinline__ bool next(int i, pg8::Unit& u) const {
        const int id = i * G + c;
        if (id < 1280) { pg8::tile_of(id, 128, 10, u.pm, u.pn); return true; }
        const int j = id - 1280; if (j >= 24) return false;
        const int q = j % 6; u.pm = 128 + j / 6; u.pn = (q < 2) ? q : q + 4; return true;
    }
    const bf16_t* A; const bf16_t* Bt;
    __device__ __forceinline__ const char* a_base(const pg8::Unit& u) const { return (const char*)(A + (size_t)u.pm * 256 * D); }
    __device__ __forceinline__ const char* b_base(const pg8::Unit& u) const { return (const char*)(Bt + (size_t)u.pn * 256 * D); }
    __device__ __forceinline__ void a_offs(const pg8::Unit&, const int (&)[2], const int (&)[2], unsigned (&)[2][2]) const {}
};
struct EpiInProj {
    bf16_t *U, *Gt, *Q, *Kimg, *Vimg; const float* rope;
    __device__ __forceinline__ void operator()(const f32x4 (&acc)[2][2][4][2], const pg8::Unit& u, int wr, int wc, int fr, int fq) const {
        const int kind = u.pn >> 1, hp = u.pn & 1; const bool lat = u.pm < 128;
#pragma unroll
        for (int ai = 0; ai < 2; ++ai)
#pragma unroll
            for (int m = 0; m < 4; ++m) {
                const int row = u.pm * 256 + ai * 128 + wr * 64 + m * 16 + fr;
                const int b = lat ? (row >> 13) : ((row - NTOK) >> 8);
                const int l = lat ? (row & 8191) : ((row - NTOK) & 255);
                const int kvrow = lat ? l : SEQ + l;
                f32x4 cs0 = {1.f, 0.f, 1.f, 0.f}, cs1 = {1.f, 0.f, 1.f, 0.f};
                if ((kind == 2 || kind == 3) && lat) { const int pos = (wc & 1) ? (l & 63) : (l >> 6); const GAS f32x4* rp = (const GAS f32x4*)(rope + (pos * 16 + 4 * fq) * 2); cs0 = rp[0]; cs1 = rp[1]; }
#pragma unroll
                for (int bj = 0; bj < 2; ++bj) {
                    f32x4 v0 = acc[ai][bj][m][0], v1 = acc[ai][bj][m][1];
                    const int ck = hp * 256 + bj * 128 + wc * 32 + fq * 8;
                    if (kind == 1) {
#pragma unroll
                        for (int j = 0; j < 4; ++j) { float x = v0[j]; float z = 0.7978845608028654f * (x + 0.044715f * x * x * x); v0[j] = x * sigmoidf_(2.f * z);
                            x = v1[j]; z = 0.7978845608028654f * (x + 0.044715f * x * x * x); v1[j] = x * sigmoidf_(2.f * z); }
                    } else if (kind == 2 || kind == 3) {
                        f32x4 t0, t1;
                        t0[0] = v0[0] * cs0[0] - v0[1] * cs0[1]; t0[1] = v0[1] * cs0[0] + v0[0] * cs0[1];
                        t0[2] = v0[2] * cs0[2] - v0[3] * cs0[3]; t0[3] = v0[3] * cs0[2] + v0[2] * cs0[3];
                        t1[0] = v1[0] * cs1[0] - v1[1] * cs1[1]; t1[1] = v1[1] * cs1[0] + v1[0] * cs1[1];
                        t1[2] = v1[2] * cs1[2] - v1[3] * cs1[3]; t1[3] = v1[3] * cs1[2] + v1[2] * cs1[3];
                        v0 = t0; v1 = t1;
                        if (kind == 2) { v0 = v0 * QSCALE; v1 = v1 * QSCALE; }
                    }
                    u32x4 w; w.x = cvt_pk_bf16(v0[0], v0[1]); w.y = cvt_pk_bf16(v0[2], v0[3]); w.z = cvt_pk_bf16(v1[0], v1[1]); w.w = cvt_pk_bf16(v1[2], v1[3]);
                    bf16_t* dst;
                    if (kind == 0) dst = U + (size_t)row * 512 + ck;
                    else if (kind == 1) dst = Gt + (size_t)row * 512 + ck;
                    else if (kind == 2) dst = Q + (size_t)row * 512 + ck;
                    else { const int head = 2 * hp + bj, t = kvrow >> 6, key = kvrow & 63; const size_t tb = ((size_t)((b * 4 + head) * NKT + t)) * 8192;
                        if (kind == 3) dst = Kimg + tb + (size_t)(((wc >> 1) * 8 + (wc & 1) * 4 + fq) * 512 + key * 8);
                        else dst = Vimg + tb + (size_t)((wc * 4 + (key >> 4)) * 512 + (key & 15) * 32 + fq * 8); }
                    *(GAS u32x4*)dst = w;
                }
            }
    }
};

__device__ __forceinline__ float swap_lo(float v, float& hi_out) { auto rr = __builtin_amdgcn_permlane32_swap(__float_as_uint(v), __float_as_uint(v), false, false); hi_out = __uint_as_float(rr[1]); return __uint_as_float(rr[0]); }

template <int DIR>
__device__ __forceinline__ void lru_scan_tile(const float (&a)[16], const float (&b)[16], int hi, float& s_in, float& p_in, float (&h)[16], float (&P)[16]) {
    float pl[16], hl[16];
#pragma unroll
    for (int g = 0; g < 4; ++g) {
        if (DIR == 0) { pl[4 * g] = a[4 * g]; hl[4 * g] = b[4 * g];
#pragma unroll
            for (int j = 1; j < 4; ++j) { pl[4 * g + j] = a[4 * g + j] * pl[4 * g + j - 1]; hl[4 * g + j] = a[4 * g + j] * hl[4 * g + j - 1] + b[4 * g + j]; }
        } else { pl[4 * g + 3] = a[4 * g + 3]; hl[4 * g + 3] = b[4 * g + 3];
#pragma unroll
            for (int j = 2; j >= 0; --j) { pl[4 * g + j] = a[4 * g + j] * pl[4 * g + j + 1]; hl[4 * g + j] = a[4 * g + j] * hl[4 * g + j + 1] + b[4 * g + j]; }
        }
    }
    float Ae[4], Ao[4], Be[4], Bo[4];
#pragma unroll
    for (int g = 0; g < 4; ++g) { const int e = (DIR == 0) ? 4 * g + 3 : 4 * g; Ae[g] = swap_lo(pl[e], Ao[g]); Be[g] = swap_lo(hl[e], Bo[g]); }
    float S = s_in, Pp = p_in;
#pragma unroll
    for (int gg = 0; gg < 4; ++gg) {
        const int g = (DIR == 0) ? gg : 3 - gg;
        float S0, P0, S1, P1;
        if (DIR == 0) { S0 = S; P0 = Pp; S = Ae[g] * S + Be[g]; Pp = Ae[g] * Pp; S1 = S; P1 = Pp; S = Ao[g] * S + Bo[g]; Pp = Ao[g] * Pp; }
        else { S0 = S; P0 = Pp; S = Ao[g] * S + Bo[g]; Pp = Ao[g] * Pp; S1 = S; P1 = Pp; S = Ae[g] * S + Be[g]; Pp = Ae[g] * Pp; }
        const bool first = (DIR == 0) ? (hi == 0) : (hi == 1);
        const float Sg = first ? S0 : S1, Pg = first ? P0 : P1;
#pragma unroll
        for (int j = 0; j < 4; ++j) { h[4 * g + j] = hl[4 * g + j] + pl[4 * g + j] * Sg; P[4 * g + j] = pl[4 * g + j] * Pg; }
    }
    s_in = S; p_in = Pp;
}

__device__ __forceinline__ void lru_unit(Frame& F, int unit) {
    const int lane = F.lane, r32 = lane & 31, hi = lane >> 5;
    const bool lat = unit < 2048;
    int b, c, n; if (lat) { n = unit & 7; c = (unit >> 3) & 63; b = unit >> 9; } else { const int j = unit - 2048; n = j & 7; c = (j >> 3) & 1; b = j >> 4; }
    const int L = lat ? SEQ : CTXL; const int rowbase = lat ? b * SEQ : NTOK + b * CTXL; const int t0 = c * 128;
    const bf16_t* U = (const bf16_t*)(F.ws + WS_U);
    LAS unsigned char* xl = F.lds + F.wave * 18432;
    {
        const int cg = lane & 7, tr = lane >> 3; const int ch0 = n * 64 + cg * 8;
        float cw[4][8], cb[8];
#pragma unroll
        for (int tap = 0; tap < 4; ++tap) { const f32x4 w0 = *(const GAS f32x4*)(F.in[IN_CONVW] + tap * 512 + ch0), w1 = *(const GAS f32x4*)(F.in[IN_CONVW] + tap * 512 + ch0 + 4);
#pragma unroll
            for (int j = 0; j < 4; ++j) { cw[tap][j] = w0[j]; cw[tap][4 + j] = w1[j]; } }
        { const f32x4 w0 = *(const GAS f32x4*)(F.in[IN_CONVB] + ch0), w1 = *(const GAS f32x4*)(F.in[IN_CONVB] + ch0 + 4);
#pragma unroll
            for (int j = 0; j < 4; ++j) { cb[j] = w0[j]; cb[4 + j] = w1[j]; } }
#pragma unroll 2
        for (int pass = 0; pass < 16; ++pass) {
            const int tl = pass * 8 + tr, t = t0 + tl;
            float a[8];
#pragma unroll
            for (int j = 0; j < 8; ++j) a[j] = cb[j];
#pragma unroll
            for (int tap = 0; tap < 4; ++tap) { const int tt = t + tap - 2;
                if (tt >= 0 && tt < L) { const u32x4 w = *(const GAS u32x4*)(U + (size_t)(rowbase + tt) * 512 + ch0);
                    a[0] += cw[tap][0] * bflo(w.x); a[1] += cw[tap][1] * bfhi(w.x); a[2] += cw[tap][2] * bflo(w.y); a[3] += cw[tap][3] * bfhi(w.y);
                    a[4] += cw[tap][4] * bflo(w.z); a[5] += cw[tap][5] * bfhi(w.z); a[6] += cw[tap][6] * bflo(w.w); a[7] += cw[tap][7] * bfhi(w.w); } }
            u32x4 o; o.x = cvt_pk_bf16(a[0], a[1]); o.y = cvt_pk_bf16(a[2], a[3]); o.z = cvt_pk_bf16(a[4], a[5]); o.w = cvt_pk_bf16(a[6], a[7]);
            *(LAS u32x4*)(xl + tl * 144 + cg * 16) = o;
        }
        LDS_WAIT(); asm volatile("" ::: "memory");
    }
    const bf16_t* LW = (const bf16_t*)(F.ws + WS_LRUW);
    bf16_t* HS = (bf16_t*)(F.ws + WS_HS); bf16_t* PF = (bf16_t*)(F.ws + WS_PF); bf16_t* PB = (bf16_t*)(F.ws + WS_PB);
    float* SUM = (float*)(F.ws + WS_SUM);
    const int sidx = lat ? 2 + c : c;
#pragma unroll 1
    for (int half = 0; half < 2; ++half) {
        const int ch = n * 64 + half * 32 + r32;
        float hf[4][16];
#pragma unroll 1
        for (int dir = 0; dir < 2; ++dir) {
            const float ba = F.in[IN_LRUBA][dir * 512 + ch], bi = F.in[IN_LRUBI][dir * 512 + ch];
            const float lam = F.in[IN_LRULAM][dir * 512 + ch];
            const float k2 = -8.f * LOG2E * log1pf(__expf(-lam));
            bf16x8 Ba[4], Bi[4];
#pragma unroll
            for (int kk = 0; kk < 4; ++kk) { Ba[kk] = *(const GAS bf16x8*)(LW + ((size_t)((dir * 2 + 0) * 8 + n) * 64 + half * 32 + r32) * 64 + kk * 16 + hi * 8);
                Bi[kk] = *(const GAS bf16x8*)(LW + ((size_t)((dir * 2 + 1) * 8 + n) * 64 + half * 32 + r32) * 64 + kk * 16 + hi * 8); }
            float s_in = 0.f, p_in = 1.f;
            bf16_t* pd = (dir ? PB : PF) + (size_t)(rowbase + t0 + 4 * hi) * 512 + ch;
            bf16_t* hd = HS + (size_t)(rowbase + t0 + 4 * hi) * 512 + ch;
#pragma unroll
            for (int mi = 0; mi < 4; ++mi) {
                const int mt = dir ? 3 - mi : mi;
                const LAS unsigned char* xt = xl + mt * 32 * 144;
                f32x16 Ca = {}, Ci = {};
#pragma unroll
                for (int kk = 0; kk < 4; ++kk) { const bf16x8 af = *(const LAS bf16x8*)(xt + r32 * 144 + kk * 32 + hi * 16);
                    Ca = __builtin_amdgcn_mfma_f32_32x32x16_bf16(af, Ba[kk], Ca, 0, 0, 0); Ci = __builtin_amdgcn_mfma_f32_32x32x16_bf16(af, Bi[kk], Ci, 0, 0, 0); }
                float av[16], bv[16];
#pragma unroll
                for (int r = 0; r < 16; ++r) {
                    const float xc = bf2f(*(const LAS unsigned short*)(xt + ((r & 3) + 8 * (r >> 2)) * 144 + hi * 4 * 144 + (half * 32 + r32) * 2));
                    const float rg = sigmoidf_(Ca[r] + ba), ig = sigmoidf_(Ci[r] + bi);
                    const float a = fexp2(rg * k2);
                    const float mult = __builtin_amdgcn_sqrtf(fmaxf(1.f - a * a, 0.f));
                    av[r] = a; bv[r] = mult * ig * xc;
                }
                float h[16], P[16];
                if (dir == 0) lru_scan_tile<0>(av, bv, hi, s_in, p_in, h, P); else lru_scan_tile<1>(av, bv, hi, s_in, p_in, h, P);
                if (lat) {
                    bf16_t* pdt = pd + (size_t)mt * 32 * 512; bf16_t* hdt = hd + (size_t)mt * 32 * 512;
#pragma unroll
                    for (int r = 0; r < 16; ++r) { const int o = ((r & 3) + 8 * (r >> 2)) * 512;
                        pdt[o] = (bf16_t)(cvt_pk_bf16(P[r], 0.f) & 0xffffu);
                        if (dir == 0) hf[mi][r] = h[r]; else hdt[o] = (bf16_t)(cvt_pk_bf16(hf[3 - mi][r] + h[r], 0.f) & 0xffffu); }
                }
                __builtin_amdgcn_sched_barrier(0);
            }
            if (hi == 0) { float* sp = SUM + ((size_t)((dir * NB + b) * NSUMC + sidx) * 512 + ch) * 2; sp[0] = p_in; sp[1] = s_in; }
        }
    }
    LDS_WAIT(); asm volatile("" ::: "memory");
}

#define ATT_WAIT_BAR(N) asm volatile("s_waitcnt vmcnt(" #N ")\n\ts_barrier" ::: "memory")
__device__ __forceinline__ s16x4 vtr(const LAS char* p) { typedef short v4i16_t __attribute__((ext_vector_type(4))); return __builtin_bit_cast(s16x4, __builtin_amdgcn_ds_read_tr16_b64_v4i16((LAS v4i16_t*)p)); }
__device__ __forceinline__ void attn_unit(Frame& F, int b, int h, int qb, float lam) {
    const int lane = F.lane, r32 = lane & 31, hi = lane >> 5, wid = F.wave; const int m = wid & 1, qg = wid >> 1;
    LAS unsigned char* lds = F.lds;
    constexpr int KS = 0, VS = 49152, WSF = 98304, XCH = 0, OST = 65536;
    const bf16_t* Kt = (const bf16_t*)(F.ws + WS_K) + (size_t)((b * 4 + h) * NKT) * 8192 + wid * 1024 + lane * 8;
    const bf16_t* Vt = (const bf16_t*)(F.ws + WS_V) + (size_t)((b * 4 + h) * NKT) * 8192 + wid * 1024 + lane * 8;
#define ATT_DMA(t, slot) do { \
        __builtin_amdgcn_global_load_lds((const unsigned*)(Kt + (size_t)(t) * 8192), (LAS unsigned*)(lds + KS + (slot) * 16384 + wid * 2048), 16, 0, 0); \
        __builtin_amdgcn_global_load_lds((const unsigned*)(Kt + (size_t)(t) * 8192 + 512), (LAS unsigned*)(lds + KS + (slot) * 16384 + wid * 2048 + 1024), 16, 0, 0); \
        __builtin_amdgcn_global_load_lds((const unsigned*)(Vt + (size_t)(t) * 8192), (LAS unsigned*)(lds + VS + (slot) * 16384 + wid * 2048), 16, 0, 0); \
        __builtin_amdgcn_global_load_lds((const unsigned*)(Vt + (size_t)(t) * 8192 + 512), (LAS unsigned*)(lds + VS + (slot) * 16384 + wid * 2048 + 1024), 16, 0, 0); } while (0)
    const int qrow0 = b * SEQ + qb * 128 + qg * 32;
    bf16x8 qr[4];
    { const bf16_t* Qw = (const bf16_t*)(F.ws + WS_Q) + (size_t)(qrow0 + r32) * 512 + h * 128 + m * 64 + hi * 8;
#pragma unroll
      for (int d0 = 0; d0 < 4; ++d0) qr[d0] = *(const GAS bf16x8*)(Qw + d0 * 16); }
    ATT_DMA(0, 0); ATT_DMA(1, 1);
    f32x16 o[4]; o[0] = f32x16{}; o[1] = f32x16{}; o[2] = f32x16{}; o[3] = f32x16{};
    float lsum = 0.f;
    const LAS char* kp0 = (const LAS char*)lds + KS + (m * 8 + hi) * 1024 + r32 * 16;
    const LAS char* vp0 = (const LAS char*)lds + VS + ((lane >> 4) & 1) * 32 + (lane & 3) * 8 + (4 * hi + ((lane & 15) >> 2)) * 64;
    int slot = 0;
#pragma unroll 1
    for (int t = 0; t < NKT; ++t) {
        if (t + 1 < NKT) ATT_WAIT_BAR(4); else ATT_WAIT_BAR(0);
        if (t + 2 < NKT) { const int s2 = (slot == 0) ? 2 : slot - 1; ATT_DMA(t + 2, s2); }
        const LAS char* kp = kp0 + slot * 16384; const LAS char* vp = vp0 + slot * 16384;
        f32x16 s0 = {}, s1 = {};
#pragma unroll
        for (int d0 = 0; d0 < 4; ++d0) {
            const bf16x8 k0 = *(const LAS bf16x8*)(kp + d0 * 2048), k1 = *(const LAS bf16x8*)(kp + d0 * 2048 + 512);
            s0 = __builtin_amdgcn_mfma_f32_32x32x16_bf16(k0, qr[d0], s0, 0, 0, 0);
            s1 = __builtin_amdgcn_mfma_f32_32x32x16_bf16(k1, qr[d0], s1, 0, 0, 0);
        }
        float sa = 0.f, sb = 0.f;
#pragma unroll
        for (int r = 0; r < 16; ++r) { s0[r] = fexp2(s0[r]); s1[r] = fexp2(s1[r]); sa += s0[r]; sb += s1[r]; }
        lsum += sa + sb;
        bf16x8 pa[4];
#pragma unroll
        for (int ks = 0; ks < 4; ++ks) { u32x4 w;
            if (ks < 2) { w.x = cvt_pk_bf16(s0[8 * ks + 0], s0[8 * ks + 1]); w.y = cvt_pk_bf16(s0[8 * ks + 2], s0[8 * ks + 3]); w.z = cvt_pk_bf16(s0[8 * ks + 4], s0[8 * ks + 5]); w.w = cvt_pk_bf16(s0[8 * ks + 6], s0[8 * ks + 7]); }
            else { const int q = ks - 2; w.x = cvt_pk_bf16(s1[8 * q + 0], s1[8 * q + 1]); w.y = cvt_pk_bf16(s1[8 * q + 2], s1[8 * q + 3]); w.z = cvt_pk_bf16(s1[8 * q + 4], s1[8 * q + 5]); w.w = cvt_pk_bf16(s1[8 * q + 6], s1[8 * q + 7]); }
            pa[ks] = __builtin_bit_cast(bf16x8, w); }
#pragma unroll
        for (int db = 0; db < 4; ++db)
#pragma unroll
            for (int ks = 0; ks < 4; ++ks) {
                const s16x4 lo = vtr(vp + (db * 4 + ks) * 1024), hh = vtr(vp + (db * 4 + ks) * 1024 + 512);
                const bf16x8 vf = (bf16x8){lo[0], lo[1], lo[2], lo[3], hh[0], hh[1], hh[2], hh[3]};
                o[db] = __builtin_amdgcn_mfma_f32_32x32x16_bf16(pa[ks], vf, o[db], 0, 0, 0);
            }
        slot = (slot == 2) ? 0 : slot + 1;
    }
    { float ph; const float pl = swap_lo(lsum, ph); lsum = pl + ph; }
    LAS float* wsf = (LAS float*)(lds + WSF) + wid * 64;
    if (hi == 0) wsf[r32] = lsum;
    LDS_WAIT(); asm volatile("" ::: "memory");
    float rl[16];
#pragma unroll
    for (int r = 0; r < 16; ++r) rl[r] = frcp(wsf[crow(r, hi)]);
    ATT_WAIT_BAR(0);
    LAS float* xch = (LAS float*)(lds + XCH) + qg * 4096;
    if (m == 1) {
#pragma unroll
        for (int db = 0; db < 4; ++db)
#pragma unroll
            for (int r = 0; r < 16; ++r) xch[(db * 16 + r) * 64 + lane] = lam * o[db][r] * rl[r];
    }
    LDS_WAIT(); ATT_WAIT_BAR(0);
    if (m == 0) {
        float ss[16];
#pragma unroll
        for (int r = 0; r < 16; ++r) ss[r] = 0.f;
#pragma unroll
        for (int db = 0; db < 4; ++db)
#pragma unroll
            for (int r = 0; r < 16; ++r) { const float d = o[db][r] * rl[r] - xch[(db * 16 + r) * 64 + lane]; o[db][r] = d; ss[r] += d * d; }
#pragma unroll
        for (int r = 0; r < 16; ++r) {
#pragma unroll
            for (int off = 1; off < 32; off <<= 1) ss[r] += __shfl_xor(ss[r], off);
            ss[r] = __builtin_amdgcn_rsqf(ss[r] * (1.f / 128.f) + LN_EPS) * (1.f - LAM_INIT);
        }
        LAS bf16_t* stg = (LAS bf16_t*)(lds + OST) + qg * 4096;
#pragma unroll
        for (int db = 0; db < 4; ++db) { const float g = F.in[IN_ANG][h * 128 + db * 32 + r32];
#pragma unroll
            for (int r = 0; r < 16; ++r) stg[crow(r, hi) * 128 + db * 32 + r32] = (bf16_t)(cvt_pk_bf16(o[db][r] * ss[r] * g, 0.f) & 0xffffu); }
        LDS_WAIT(); asm volatile("" ::: "memory");
        bf16_t* Y = (bf16_t*)(F.ws + WS_A) + (size_t)qrow0 * D + 512 + h * 128;
#pragma unroll
        for (int i = 0; i < 8; ++i) { const int row = i * 4 + (lane >> 4), chk = lane & 15; const u32x4 v = *(const LAS u32x4*)(stg + row * 128 + chk * 8); *(GAS u32x4*)(Y + (size_t)row * D + chk * 8) = v; }
    }
    LDS_WAIT(); ATT_WAIT_BAR(0);
#undef ATT_DMA
}
__device__ __forceinline__ void p3_lru_attn(Frame& F) {
#ifndef NO_LRU
    for (int u = F.vcu * NWAVES + F.wave; u < 2048 + 64; u += F.G * NWAVES) lru_unit(F, u);
#endif
    VM_WAIT(); __syncthreads();
    float lam;
    { const float* dl = F.in[IN_DLAM]; const float a = wave_sum(dl[F.lane] * dl[64 + F.lane]), bq = wave_sum(dl[128 + F.lane] * dl[192 + F.lane]); lam = __expf(a) - __expf(bq) + LAM_INIT; }
    for (int u = F.vcu * 4; u < NB * NHEAD * 64; u += F.G * 4) {
#ifndef NO_ATT
        for (int i = 0; i < 4; ++i) { const int id = u + i; attn_unit(F, id >> 8, (id >> 6) & 3, id & 63, lam); }
#endif
        (void)lam; }
}

__device__ __forceinline__ void p4_fixup(Frame& F) {
    LAS float* cf = (LAS float*)F.lds; LAS float* cb = cf + 512;
    const float* SUM = (const float*)(F.ws + WS_SUM);
    const bf16_t* HS = (const bf16_t*)(F.ws + WS_HS); const bf16_t* PF = (const bf16_t*)(F.ws + WS_PF); const bf16_t* PB = (const bf16_t*)(F.ws + WS_PB); const bf16_t* Gt = (const bf16_t*)(F.ws + WS_G);
    bf16_t* Y = (bf16_t*)(F.ws + WS_A);
    for (int u = F.vcu; u < NB * NCHUNK; u += F.G) {
        const int b = u >> 6, c = u & 63;
        { const int ch = F.tid;
          const f32x2* sf = (const f32x2*)SUM + (size_t)((0 * NB + b) * NSUMC) * 512 + ch; const f32x2* sb = (const f32x2*)SUM + (size_t)((1 * NB + b) * NSUMC) * 512 + ch;
          float s = 0.f;
          for (int i = 0; i < 2 + c; ++i) { const f32x2 v = sf[(size_t)i * 512]; s = v.x * s + v.y; }
          cf[ch] = s;
          s = 0.f;
          { f32x2 v = sb[(size_t)1 * 512]; s = v.x * s + v.y; v = sb[0]; s = v.x * s + v.y; }
          for (int i = NCHUNK - 1; i > c; --i) { const f32x2 v = sb[(size_t)(2 + i) * 512]; s = v.x * s + v.y; }
          cb[ch] = s; }
        __syncthreads();
        const int cg = F.tid & 63, tr = F.tid >> 6;
        float f8[8], b8[8];
#pragma unroll
        for (int j = 0; j < 8; ++j) { f8[j] = cf[cg * 8 + j]; b8[j] = cb[cg * 8 + j]; }
#pragma unroll 2
        for (int pass = 0; pass < 16; ++pass) {
            const size_t row = (size_t)b * SEQ + c * 128 + pass * 8 + tr; const size_t o = row * 512 + cg * 8;
            const u32x4 hs = *(const GAS u32x4*)(HS + o), pf = *(const GAS u32x4*)(PF + o), pb = *(const GAS u32x4*)(PB + o), gg = *(const GAS u32x4*)(Gt + o);
            float y[8];
#pragma unroll
            for (int q = 0; q < 4; ++q) {
                y[2 * q] = bflo(gg[q]) * (bflo(hs[q]) + bflo(pf[q]) * f8[2 * q] + bflo(pb[q]) * b8[2 * q]);
                y[2 * q + 1] = bfhi(gg[q]) * (bfhi(hs[q]) + bfhi(pf[q]) * f8[2 * q + 1] + bfhi(pb[q]) * b8[2 * q + 1]);
            }
            u32x4 w; w.x = cvt_pk_bf16(y[0], y[1]); w.y = cvt_pk_bf16(y[2], y[3]); w.z = cvt_pk_bf16(y[4], y[5]); w.w = cvt_pk_bf16(y[6], y[7]);
            *(GAS u32x4*)(Y + row * D + cg * 8) = w;
        }
        __syncthreads();
    }
}

struct SchedGrid {
    int G, c, nM, nN; const bf16_t* A; const bf16_t* Bt; int K;
    __device__ __forceinline__ bool next(int i, pg8::Unit& u) const { const int id = i * G + c; if (id >= nM * nN) return false; pg8::tile_of(id, nM, nN, u.pm, u.pn); return true; }
    __device__ __forceinline__ const char* a_base(const pg8::Unit& u) const { return (const char*)(A + (size_t)u.pm * 256 * K); }
    __device__ __forceinline__ const char* b_base(const pg8::Unit& u) const { return (const char*)(Bt + (size_t)u.pn * 256 * K); }
    __device__ __forceinline__ void a_offs(const pg8::Unit&, const int (&)[2], const int (&)[2], unsigned (&)[2][2]) const {}
};
struct EpiWout {
    const float* x; const float* mods; float* z;
    __device__ __forceinline__ void operator()(const f32x4 (&acc)[2][2][4][2], const pg8::Unit& u, int wr, int wc, int fr, int fq) const {
        const int b = (u.pm * 256) >> 13;
#pragma unroll
        for (int bj = 0; bj < 2; ++bj) {
            const int col = u.pn * 256 + bj * 128 + wc * 32 + fq * 8;
            const f32x4 g0 = *(const GAS f32x4*)(mods + b * 6144 + 2048 + col), g1 = *(const GAS f32x4*)(mods + b * 6144 + 2048 + col + 4);
#pragma unroll
            for (int ai = 0; ai < 2; ++ai)
#pragma unroll
                for (int m = 0; m < 4; ++m) {
                    const size_t o = (size_t)(u.pm * 256 + ai * 128 + wr * 64 + m * 16 + fr) * D + col;
                    const f32x4 x0 = *(const GAS f32x4*)(x + o), x1 = *(const GAS f32x4*)(x + o + 4);
                    *(GAS f32x4*)(z + o) = x0 * ALPHA + g0 * acc[ai][bj][m][0]; *(GAS f32x4*)(z + o + 4) = x1 * ALPHA + g1 * acc[ai][bj][m][1];
                }
        }
    }
};

__device__ __forceinline__ void p6_ln_router(Frame& F) {
    LAS f32x4* WG = (LAS f32x4*)F.lds;
    LAS f32x4* WE = (LAS f32x4*)(F.lds + 16384);
    LAS int* rowE = (LAS int*)(F.lds + 147456);
    LAS float* rowW = (LAS float*)(F.lds + 147456 + 1024);
    LAS int* rowP = (LAS int*)(F.lds + 147456 + 2048);
    LAS int* hist = (LAS int*)(F.lds + 147456 + 3072);
    LAS int* baseE = (LAS int*)(F.lds + 147456 + 3072 + 128);
    for (int i = F.tid; i < 16 * 64; i += NTHR) { const int ji = i >> 6, ln = i & 63, k = 4 * ln + 256 * (ji >> 2) + (ji & 3); WG[i] = *(const GAS f32x4*)(F.in[IN_RGW] + k * 4); }
    for (int i = F.tid; i < 8 * 16 * 64; i += NTHR) { const int ln = i & 63, ji = (i >> 6) & 15, eh = (i >> 10) & 1, g = i >> 11, k = 4 * ln + 256 * (ji >> 2) + (ji & 3);
        WE[i] = *(const GAS f32x4*)(F.in[IN_REW] + ((size_t)(g * 1024 + k)) * 8 + eh * 4); }
    if (F.tid < 32) hist[F.tid] = 0;
    __syncthreads();
    const float* mods = (const float*)(F.ws + WS_MODS);
    unsigned* cnt = (unsigned*)(F.ws + WS_CTL) + CW_CNT;
    int* LENT = (int*)(F.ws + WS_LENT); float* LWGT = (float*)(F.ws + WS_LWGT);
    for (int rg = F.vcu; rg < NTOK / 128; rg += F.G) {
        for (int rl = F.wave; rl < 128; rl += NWAVES) {
            const int row = rg * 128 + rl, b = row >> 13;
            GAS f32x4* zr = (GAS f32x4*)(F.out + (size_t)row * D) + F.lane;
            f32x4 v[4]; float s = 0.f;
#pragma unroll
            for (int j = 0; j < 4; ++j) { v[j] = zr[64 * j]; s += (v[j].x + v[j].y) + (v[j].z + v[j].w); }
            float mean = wave_sum(s) * (1.f / D); float s2 = 0.f;
#pragma unroll
            for (int j = 0; j < 4; ++j) { v[j] = v[j] - mean; s2 += (v[j].x * v[j].x + v[j].y * v[j].y) + (v[j].z * v[j].z + v[j].w * v[j].w); }
            float rstd = 1.f / sqrtf(wave_sum(s2) * (1.f / D) + LN_EPS);
            s = 0.f;
#pragma unroll
            for (int j = 0; j < 4; ++j) { const f32x4 pg = *((const GAS f32x4*)F.in[IN_POSTG] + F.lane + 64 * j), pb = *((const GAS f32x4*)F.in[IN_POSTB] + F.lane + 64 * j);
                v[j] = v[j] * rstd * pg + pb; zr[64 * j] = v[j]; s += (v[j].x + v[j].y) + (v[j].z + v[j].w); }
            mean = wave_sum(s) * (1.f / D); s2 = 0.f;
#pragma unroll
            for (int j = 0; j < 4; ++j) { v[j] = v[j] - mean; s2 += (v[j].x * v[j].x + v[j].y * v[j].y) + (v[j].z * v[j].z + v[j].w * v[j].w); }
            rstd = 1.f / sqrtf(wave_sum(s2) * (1.f / D) + LN_EPS);
            GAS u32x2* o8 = (GAS u32x2*)((bf16_t*)(F.ws + WS_A) + (size_t)row * D) + F.lane;
            f32x4 lg = {0.f, 0.f, 0.f, 0.f};
#pragma unroll
            for (int j = 0; j < 4; ++j) { const f32x4 sh = *((const GAS f32x4*)(mods + b * 6144 + 3 * 1024) + F.lane + 64 * j), sc = *((const GAS f32x4*)(mods + b * 6144 + 4 * 1024) + F.lane + 64 * j);
                v[j] = v[j] * rstd * (sc + 1.f) + sh;
                u32x2 w; w.x = cvt_pk_bf16(v[j].x, v[j].y); w.y = cvt_pk_bf16(v[j].z, v[j].w); o8[64 * j] = w;
#pragma unroll
                for (int i = 0; i < 4; ++i) lg += WG[(j * 4 + i) * 64 + F.lane] * v[j][i]; }
            float l0 = wave_sum(lg.x) + F.in[IN_RGB][0], l1 = wave_sum(lg.y) + F.in[IN_RGB][1], l2 = wave_sum(lg.z) + F.in[IN_RGB][2], l3 = wave_sum(lg.w) + F.in[IN_RGB][3];
            int gs = 0; float lm = l0; if (l1 > lm) { lm = l1; gs = 1; } if (l2 > lm) { lm = l2; gs = 2; } if (l3 > lm) { lm = l3; gs = 3; }
            gs = __builtin_amdgcn_readfirstlane(gs);
            const float pgv = 1.f / (__expf(l0 - lm) + __expf(l1 - lm) + __expf(l2 - lm) + __expf(l3 - lm));
            f32x4 ea = {0.f, 0.f, 0.f, 0.f}, eb = {0.f, 0.f, 0.f, 0.f};
            const LAS f32x4* we0 = WE + (gs * 2 + 0) * 1024 + F.lane; const LAS f32x4* we1 = WE + (gs * 2 + 1) * 1024 + F.lane;
#pragma unroll
            for (int j = 0; j < 4; ++j)
#pragma unroll
                for (int i = 0; i < 4; ++i) { ea += we0[(j * 4 + i) * 64] * v[j][i]; eb += we1[(j * 4 + i) * 64] * v[j][i]; }
            float le[8]; const float* be = F.in[IN_REB] + gs * 8;
            le[0] = wave_sum(ea.x) + be[0]; le[1] = wave_sum(ea.y) + be[1]; le[2] = wave_sum(ea.z) + be[2]; le[3] = wave_sum(ea.w) + be[3];
            le[4] = wave_sum(eb.x) + be[4]; le[5] = wave_sum(eb.y) + be[5]; le[6] = wave_sum(eb.z) + be[6]; le[7] = wave_sum(eb.w) + be[7];
            int e1 = 0; float m1 = le[0];
#pragma unroll
            for (int e = 1; e < 8; ++e) if (le[e] > m1) { m1 = le[e]; e1 = e; }
            int e2 = -1; float m2 = -INFINITY;
#pragma unroll
            for (int e = 0; e < 8; ++e) if (e != e1 && le[e] > m2) { m2 = le[e]; e2 = e; }
            const float w1 = 1.f / (1.f + __expf(m2 - m1)), w2 = 1.f - w1;
            if (F.lane == 0) { rowE[2 * rl] = gs * 8 + e1; rowE[2 * rl + 1] = gs * 8 + e2; rowW[2 * rl] = pgv * w1; rowW[2 * rl + 1] = pgv * w2; }
        }
        __syncthreads();
        if (F.tid < 256) rowP[F.tid] = atomicAdd((int*)&hist[rowE[F.tid]], 1);
        __syncthreads();
        if (F.tid < 32) { baseE[F.tid] = (int)__hip_atomic_fetch_add(&cnt[F.tid], (unsigned)hist[F.tid], __ATOMIC_RELAXED, __HIP_MEMORY_SCOPE_AGENT); hist[F.tid] = 0; }
        __syncthreads();
        if (F.tid < 256) { const int e = rowE[F.tid], pos = baseE[e] + rowP[F.tid]; const int tok = rg * 128 + (F.tid >> 1);
            LENT[(size_t)e * ECAP + pos] = tok * 2 + (F.tid & 1); LWGT[(size_t)e * ECAP + pos] = rowW[F.tid]; }
        __syncthreads();
    }
}

struct SchedMoe {
    int G, c; const LAS int* tstart;
    const unsigned* cnt; const int* lent;
    const bf16_t* A; const bf16_t* Bt; int K; size_t bexp;
    __device__ __forceinline__ bool next(int i, pg8::Unit& u) const {
        const int id = i * G + c, tile = id >> 2;
        if (tile >= tstart[32]) return false;
        int e = 0;
#pragma unroll 1
        for (int s = 16; s > 0; s >>= 1) if (tstart[e + s] <= tile) e += s;
        u.e = e; u.tile = tile; u.pm = tile - tstart[e]; u.pn = id & 3; u.cnt = (int)cnt[e]; return true;
    }
    __device__ __forceinline__ const char* a_base(const pg8::Unit& u) const { return (const char*)A + (lent ? (size_t)0 : (size_t)u.tile * 256 * K * 2); }
    __device__ __forceinline__ const char* b_base(const pg8::Unit& u) const { return (const char*)(Bt + (size_t)u.e * bexp + (size_t)u.pn * 256 * K); }
    __device__ __forceinline__ void a_offs(const pg8::Unit& u, const int (&R)[2], const int (&C)[2], unsigned (&vo)[2][2]) const {
#pragma unroll
        for (int h = 0; h < 2; ++h)
#pragma unroll
            for (int i = 0; i < 2; ++i) { const int pos = u.pm * 256 + h * 128 + R[i]; const int tok = (pos < u.cnt) ? (lent[(size_t)u.e * ECAP + pos] >> 1) : 0; vo[h][i] = (unsigned)(tok * K + C[i]) * 2u; }
    }
};
struct EpiMoe1 {
    bf16_t* act;
    __device__ __forceinline__ void operator()(const f32x4 (&acc)[2][2][4][2], const pg8::Unit& u, int wr, int wc, int fr, int fq) const {
#pragma unroll
        for (int ai = 0; ai < 2; ++ai)
#pragma unroll
            for (int m = 0; m < 4; ++m) {
                const size_t row = (size_t)u.tile * 256 + ai * 128 + wr * 64 + m * 16 + fr;
                float y[8];
#pragma unroll
                for (int n = 0; n < 2; ++n)
#pragma unroll
                    for (int j = 0; j < 4; ++j) { const float a = acc[ai][0][m][n][j]; y[4 * n + j] = a * sigmoidf_(a) * acc[ai][1][m][n][j]; }
                u32x4 w; w.x = cvt_pk_bf16(y[0], y[1]); w.y = cvt_pk_bf16(y[2], y[3]); w.z = cvt_pk_bf16(y[4], y[5]); w.w = cvt_pk_bf16(y[6], y[7]);
                *(GAS u32x4*)(act + row * 512 + u.pn * 128 + wc * 32 + fq * 8) = w;
            }
    }
};
struct EpiMoe2 {
    bf16_t* ys; const int* lent; const float* lwgt;
    __device__ __forceinline__ void operator()(const f32x4 (&acc)[2][2][4][2], const pg8::Unit& u, int wr, int wc, int fr, int fq) const {
#pragma unroll
        for (int ai = 0; ai < 2; ++ai)
#pragma unroll
            for (int m = 0; m < 4; ++m) {
                const int pos = u.pm * 256 + ai * 128 + wr * 64 + m * 16 + fr;
                if (pos < u.cnt) {
                    const int ent = lent[(size_t)u.e * ECAP + pos]; const float w = lwgt[(size_t)u.e * ECAP + pos];
#pragma unroll
                    for (int bj = 0; bj < 2; ++bj) { const f32x4 v0 = acc[ai][bj][m][0] * w, v1 = acc[ai][bj][m][1] * w;
                        u32x4 o; o.x = cvt_pk_bf16(v0[0], v0[1]); o.y = cvt_pk_bf16(v0[2], v0[3]); o.z = cvt_pk_bf16(v1[0], v1[1]); o.w = cvt_pk_bf16(v1[2], v1[3]);
                        *(GAS u32x4*)(ys + (size_t)ent * D + u.pn * 256 + bj * 128 + wc * 32 + fq * 8) = o; }
                }
            }
    }
};
__device__ __forceinline__ void moe_tile_table(Frame& F) {
    LAS int* ts = (LAS int*)(F.lds + MISC_OFF + 256);
    if (F.tid == 0) { const unsigned* cnt = (const unsigned*)(F.ws + WS_CTL) + CW_CNT; int acc = 0; for (int e = 0; e < 32; ++e) { ts[e] = acc; acc += ((int)cnt[e] + 255) >> 8; } ts[32] = acc; }
    __syncthreads();
}

__device__ __forceinline__ void p9_final(Frame& F) {
    const int gw = F.vcu * NWAVES + F.wave, NGW = F.G * NWAVES;
    const float* mods = (const float*)(F.ws + WS_MODS);
    const bf16_t* YS = (const bf16_t*)(F.ws + WS_YS);
    for (int r = gw; r < NTOK; r += NGW) {
        const int b = r >> 13;
        GAS f32x4* xr = (GAS f32x4*)(F.out + (size_t)r * D) + F.lane;
        const GAS u32x2* y0 = (const GAS u32x2*)(YS + (size_t)r * 2 * D) + F.lane; const GAS u32x2* y1 = (const GAS u32x2*)(YS + (size_t)r * 2 * D + D) + F.lane;
        f32x4 v[4]; float s = 0.f;
#pragma unroll
        for (int j = 0; j < 4; ++j) { const f32x4 xm = xr[64 * j]; const u32x2 a = y0[64 * j], c = y1[64 * j]; const f32x4 g2 = *((const GAS f32x4*)(mods + b * 6144 + 5 * 1024) + F.lane + 64 * j);
            f32x4 y; y.x = bflo(a.x) + bflo(c.x); y.y = bfhi(a.x) + bfhi(c.x); y.z = bflo(a.y) + bflo(c.y); y.w = bfhi(a.y) + bfhi(c.y);
            v[j] = xm * ALPHA + g2 * y; s += (v[j].x + v[j].y) + (v[j].z + v[j].w); }
        const float mean = wave_sum(s) * (1.f / D); float s2 = 0.f;
#pragma unroll
        for (int j = 0; j < 4; ++j) { v[j] = v[j] - mean; s2 += (v[j].x * v[j].x + v[j].y * v[j].y) + (v[j].z * v[j].z + v[j].w * v[j].w); }
        const float rstd = 1.f / sqrtf(wave_sum(s2) * (1.f / D) + LN_EPS);
#pragma unroll
        for (int j = 0; j < 4; ++j) { const f32x4 pg = *((const GAS f32x4*)(F.in[IN_POSTG] + D) + F.lane + 64 * j), pb = *((const GAS f32x4*)(F.in[IN_POSTB] + D) + F.lane + 64 * j);
            xr[64 * j] = v[j] * rstd * pg + pb; }
    }
}

constexpr int N_PHASES = 10;
struct Args { const float* in[26]; float* out; unsigned char* ws; int ph_lo, ph_hi; };
__global__ void __launch_bounds__(NTHR, 2) fwd_kernel(Args args) {
    extern __shared__ __attribute__((aligned(16))) unsigned char lds_raw[];
    Frame F;
    F.lds = (LAS unsigned char*)lds_raw;
    F.MISC = (volatile LAS unsigned*)(F.lds + MISC_OFF);
    F.tid = threadIdx.x; F.lane = F.tid & 63; F.wave = __builtin_amdgcn_readfirstlane(F.tid >> 6);
    F.G = gridDim.x; { const int bx = blockIdx.x; F.vcu = (F.G % 8 == 0) ? (bx % 8) * (F.G / 8) + bx / 8 : bx; }
    F.ws = args.ws; F.in = args.in; F.out = args.out;
    for (int u = F.tid; u < (LDS_BYTES - MISC_OFF) / 4; u += NTHR) ((LAS unsigned*)(F.lds + MISC_OFF))[u] = 0u;
    __syncthreads();
    const int lo = args.ph_lo, hi = args.ph_hi;
    XcdBarrier bar; bar.bar = (unsigned*)(F.ws + WS_CTL) + CW_BAR; bar.x = 0; bar.st = nullptr;
    if (hi - lo > 1) bar = xcd_barrier_post((unsigned*)(F.ws + WS_CTL) + CW_BAR, F.MISC + 8);
#ifndef PHASE_MASK
#define PHASE_MASK 0x3ff
#endif
#define IN(k) ((((PHASE_MASK) >> (k)) & 1) && lo <= (k) && (k) < hi)
#define SEAM(k) do { if (IN(k) && IN((k) + 1)) xcd_barrier(bar); } while (0)
    if (IN(0)) { p0_prologue(F); } SEAM(0);
    if (IN(1)) { p1_ln1(F); } SEAM(1);
    if (IN(2)) {
        SchedInProj S{F.G, (int)blockIdx.x, (const bf16_t*)(F.ws + WS_A), (const bf16_t*)(F.ws + WS_WIN)};
        EpiInProj E{(bf16_t*)(F.ws + WS_U), (bf16_t*)(F.ws + WS_G), (bf16_t*)(F.ws + WS_Q), (bf16_t*)(F.ws + WS_K), (bf16_t*)(F.ws + WS_V), (const float*)(F.ws + WS_ROPE)};
        pg8::gemm_phase<EpiInProj, SchedInProj, true, false>(F.lds, D, S, E);
    } SEAM(2);
    if (IN(3)) { p3_lru_attn(F); } SEAM(3);
    if (IN(4)) { p4_fixup(F); } SEAM(4);
    if (IN(5)) {
        SchedGrid S{F.G, (int)blockIdx.x, NTOK / 256, D / 256, (const bf16_t*)(F.ws + WS_A), (const bf16_t*)(F.ws + WS_WOUT), D};
        EpiWout E{F.in[IN_X], (const float*)(F.ws + WS_MODS), F.out};
        pg8::gemm_phase<EpiWout, SchedGrid, true, false>(F.lds, D, S, E);
    } SEAM(5);
    if (IN(6)) { p6_ln_router(F); } SEAM(6);
    if (IN(7)) {
        moe_tile_table(F);
        SchedMoe S{F.G, (int)blockIdx.x, (const LAS int*)(F.lds + MISC_OFF + 256), (const unsigned*)(F.ws + WS_CTL) + CW_CNT, (const int*)(F.ws + WS_LENT), (const bf16_t*)(F.ws + WS_A), (const bf16_t*)(F.ws + WS_BT1), D, (size_t)1024 * 1024};
        EpiMoe1 E{(bf16_t*)(F.ws + WS_ACT)};
        pg8::gemm_phase<EpiMoe1, SchedMoe, true, true>(F.lds, D, S, E);
    } SEAM(7);
    if (IN(8)) {
        moe_tile_table(F);
        SchedMoe S{F.G, (int)blockIdx.x, (const LAS int*)(F.lds + MISC_OFF + 256), (const unsigned*)(F.ws + WS_CTL) + CW_CNT, nullptr, (const bf16_t*)(F.ws + WS_ACT), (const bf16_t*)(F.ws + WS_BT2), DEXP, (size_t)1024 * 512};
        EpiMoe2 E{(bf16_t*)(F.ws + WS_YS), (const int*)(F.ws + WS_LENT), (const float*)(F.ws + WS_LWGT)};
        pg8::gemm_phase<EpiMoe2, SchedMoe, true, false>(F.lds, DEXP, S, E);
    } SEAM(8);
    if (IN(9)) { p9_final(F); }
#undef IN
#undef SEAM
}

extern "C" void kernel_launch(void* const* d_in, const int* in_sizes, int n_in, void* d_out, int out_size, void* d_ws, size_t ws_size, hipStream_t stream) {
    static int grid = 0;
    if (grid == 0) {
        if (n_in != 26 || out_size != NTOK * D || ws_size < WS_END) { fprintf(stderr, "kernel_launch: unexpected shapes (n_in %d, out %d, ws %zu)\n", n_in, out_size, ws_size); grid = -1; return; }
        int dev = 0, cus = 0;
        if (hipGetDevice(&dev) != hipSuccess || hipDeviceGetAttribute(&cus, hipDeviceAttributeMultiprocessorCount, dev) != hipSuccess) { grid = -1; return; }
        if (hipFuncSetAttribute((const void*)fwd_kernel, hipFuncAttributeMaxDynamicSharedMemorySize, LDS_BYTES) != hipSuccess) { fprintf(stderr, "kernel_launch: hipFuncSetAttribute failed\n"); grid = -1; return; }
        int per_cu = 0;
        if (hipOccupancyMaxActiveBlocksPerMultiprocessor(&per_cu, (const void*)fwd_kernel, NTHR, LDS_BYTES) != hipSuccess || per_cu < 1) fprintf(stderr, "kernel_launch: occupancy query reports %d\n", per_cu);
        (void)hipGetLastError();
        grid = cus;
    }
    if (grid < 0) return;
    if (hipMemsetAsync((char*)d_ws + WS_CTL, 0, CTL_ZERO_BYTES, stream) != hipSuccess) return;
    Args a{};
    for (int i = 0; i < 26; ++i) a.in[i] = (const float*)d_in[i];
    a.out = (float*)d_out; a.ws = (unsigned char*)d_ws;
#if MK_N_LAUNCHES == 1
    a.ph_lo = 0; a.ph_hi = N_PHASES;
    hipLaunchKernelGGL(fwd_kernel, dim3(grid), dim3(NTHR), LDS_BYTES, stream, a);
#else
    for (int p = 0; p < N_PHASES; ++p) { a.ph_lo = p; a.ph_hi = p + 1; hipLaunchKernelGGL(fwd_kernel, dim3(grid), dim3(NTHR), LDS_BYTES, stream, a); }
#endif
}
```
